# Optimizing an MI355X kernel written in HIP

```python
import math
import jax, jax.numpy as jnp
from jax import lax
import numpy as np

D_MODEL = 2048
BATCH = 4
SEQ = 2048
DEPTH = 1

D_RNN = 2048
RNN_BLOCKS = 16
RNN_BLOCK_W = D_RNN // RNN_BLOCKS
CONV_W = 4
LRU_C = 8.0
HEAD_DIM = 128
HEADS_PER_GROUP = 8
DILATED_GROUPS = ((128, 1), (512, 4), (2048, 16))
N_GROUPS = len(DILATED_GROUPS)
N_ATTN_HEADS = N_GROUPS * HEADS_PER_GROUP
D_QKV = N_ATTN_HEADS * HEAD_DIM
D_ATTN_OUT = HEADS_PER_GROUP * HEAD_DIM
ATTN_BLOCK = 128
ROPE_THETA = 500000.0
ROT_DIM = HEAD_DIM // 4
NORM_EPS = 1e-6
SPLIT_SIZES = (D_RNN, D_RNN, D_QKV, D_QKV, D_QKV, D_ATTN_OUT, D_MODEL, D_MODEL)
D_IN_TOTAL = 2 * D_RNN + 3 * D_QKV + D_ATTN_OUT + 2 * D_MODEL

kernel_name = "hybrid_rglru_dilated_attn_block"


def rms_norm(x, g):
    xf = x.astype(jnp.float32)
    y = xf * lax.rsqrt(jnp.mean(xf * xf, axis=-1, keepdims=True) + NORM_EPS)
    return (y * g.astype(jnp.float32)).astype(x.dtype)


def split_columns(p):
    offs, acc = [], 0
    for s in SPLIT_SIZES[:-1]:
        acc += s
        offs.append(acc)
    return jnp.split(p, offs, axis=-1)


def partial_rope(t, pos):
    half = ROT_DIM // 2
    inv = jnp.exp(-math.log(ROPE_THETA) * jnp.arange(half, dtype=jnp.float32) * (2.0 / ROT_DIM))
    ang = pos.astype(jnp.float32)[:, None] * inv[None, :]
    cos = jnp.cos(ang)[None, :, None, :]
    sin = jnp.sin(ang)[None, :, None, :]
    tr = t[..., :ROT_DIM].astype(jnp.float32)
    t1, t2 = tr[..., :half], tr[..., half:]
    rot = jnp.concatenate([t1 * cos - t2 * sin, t2 * cos + t1 * sin], axis=-1)
    return jnp.concatenate([rot.astype(t.dtype), t[..., ROT_DIM:]], axis=-1)


def rg_lru(u, conv_w, conv_b, w_rg, b_rg, w_ig, b_ig, lru_lambda):
    B, S, C = u.shape
    xc = lax.conv_general_dilated(
        u, conv_w[:, None, :].astype(u.dtype), window_strides=(1,), padding=[(CONV_W - 1, 0)],
        dimension_numbers=("NWC", "WIO", "NWC"), feature_group_count=C) + conv_b
    xb = xc.reshape(B, S, RNN_BLOCKS, RNN_BLOCK_W)
    r = jax.nn.sigmoid(jnp.einsum('bsnc,ncd->bsnd', xb, w_rg).reshape(B, S, C) + b_rg)
    i = jax.nn.sigmoid(jnp.einsum('bsnc,ncd->bsnd', xb, w_ig).reshape(B, S, C) + b_ig)
    log_a = -LRU_C * r.astype(jnp.float32) * jax.nn.softplus(-lru_lambda.astype(jnp.float32))
    a = jnp.exp(log_a)
    b = jnp.sqrt(-jnp.expm1(2.0 * log_a)) * (i * xc).astype(jnp.float32)

    def combine(left, right):
        a1, b1 = left
        a2, b2 = right
        return a1 * a2, a2 * b1 + b2

    _, h = lax.associative_scan(combine, (a, b), axis=1)
    return h.astype(u.dtype)


def dilated_group_attention(q, k, v, window, dilation):
    B, S, H, D = q.shape
    L = S // dilation
    steps = window // dilation
    n_blk = -(-L // ATTN_BLOCK)
    Lp = n_blk * ATTN_BLOCK

    def to_blocks(t):
        t = t.reshape(B, L, dilation, H, D).transpose(0, 2, 1, 3, 4)
        t = jnp.pad(t, ((0, 0), (0, 0), (0, Lp - L), (0, 0), (0, 0)))
        return t.reshape(B, dilation, n_blk, ATTN_BLOCK, H, D)

    def with_prev(t):
        prev = jnp.pad(t, ((0, 0), (0, 0), (1, 0), (0, 0), (0, 0), (0, 0)))[:, :, :-1]
        return jnp.concatenate([prev, t], axis=3)

    qb = to_blocks(q).astype(jnp.float32)
    kk = with_prev(to_blocks(k)).astype(jnp.float32)
    vv = with_prev(to_blocks(v)).astype(jnp.float32)
    s = jnp.einsum('brnqhd,brnkhd->brnhqk', qb, kk) * (D ** -0.5)
    qi = jnp.arange(ATTN_BLOCK)[:, None]
    kj = jnp.arange(2 * ATTN_BLOCK)[None, :]
    dist = qi + ATTN_BLOCK - kj
    key_pos = jnp.arange(n_blk)[:, None, None] * ATTN_BLOCK + kj[None] - ATTN_BLOCK
    valid = (dist >= 0)[None] & (dist <= steps)[None] & (key_pos >= 0)
    s = jnp.where(valid[None, None, :, None], s, -1e30)
    m = jnp.max(s, axis=-1)
    p = jnp.exp(s - m[..., None])
    l = jnp.sum(p, axis=-1)
    o = jnp.einsum('brnhqk,brnkhd->brnqhd', p, vv) / jnp.swapaxes(l, -1, -2)[..., None]
    log_den = jnp.swapaxes(m + jnp.log(l), -1, -2)

    def from_blocks(t):
        rest = t.shape[4:]
        t = t.reshape((B, dilation, Lp) + rest)[:, :, :L]
        t = jnp.moveaxis(t, 1, 2)
        return t.reshape((B, S) + rest)

    return from_blocks(o), from_blocks(log_den)


def setup_inputs(seed: int = 0) -> dict:
    key = jax.random.key(seed)
    ks = jax.random.split(key, 16)
    f32 = jnp.float32
    nrm = lambda k, shape, scale: jax.random.normal(k, shape, f32) * scale
    u = jax.random.uniform(ks[8], (DEPTH, D_RNN), f32, 0.9, 0.999)
    s = u ** (1.0 / LRU_C)
    lru_lambda = jnp.log(s) - jnp.log1p(-s)
    return {
        "x": jax.random.normal(ks[0], (BATCH, SEQ, D_MODEL), f32),
        "ln_pre_g": 1.0 + nrm(ks[1], (DEPTH, D_MODEL), 0.02),
        "w_in": nrm(ks[2], (DEPTH, D_MODEL, D_IN_TOTAL), D_MODEL ** -0.5),
        "conv_w": nrm(ks[3], (DEPTH, CONV_W, D_RNN), CONV_W ** -0.5),
        "conv_b": nrm(ks[4], (DEPTH, D_RNN), 0.02),
        "w_rg": nrm(ks[5], (DEPTH, RNN_BLOCKS, RNN_BLOCK_W, RNN_BLOCK_W), RNN_BLOCK_W ** -0.5),
        "b_rg": nrm(ks[6], (DEPTH, D_RNN), 0.02),
        "w_ig": nrm(ks[7], (DEPTH, RNN_BLOCKS, RNN_BLOCK_W, RNN_BLOCK_W), RNN_BLOCK_W ** -0.5),
        "b_ig": nrm(ks[9], (DEPTH, D_RNN), 0.02),
        "lru_lambda": lru_lambda,
        "w_rnn_out": nrm(ks[10], (DEPTH, D_RNN, D_MODEL), D_RNN ** -0.5),
        "w_attn_out": nrm(ks[11], (DEPTH, D_ATTN_OUT, D_MODEL), D_ATTN_OUT ** -0.5),
        "w_o": nrm(ks[12], (DEPTH, D_MODEL, D_MODEL), D_MODEL ** -0.5),
        "ln_post_g": 1.0 + nrm(ks[13], (DEPTH, D_MODEL), 0.02),
    }


def reference(x, ln_pre_g, w_in, conv_w, conv_b, w_rg, b_rg, w_ig, b_ig, lru_lambda,
              w_rnn_out, w_attn_out, w_o, ln_post_g):
    B, S, _ = x.shape
    pos = jnp.arange(S)
    for layer in range(DEPTH):
        h = rms_norm(x, ln_pre_g[layer])
        proj = jnp.einsum('bsd,de->bse', h, w_in[layer])
        rnn_x, rnn_gate, q, k, v, attn_gate, g_rnn, g_attn = split_columns(proj)

        hr = rg_lru(rnn_x, conv_w[layer], conv_b[layer], w_rg[layer], b_rg[layer],
                    w_ig[layer], b_ig[layer], lru_lambda[layer])
        y_rnn = jnp.einsum('bsc,cd->bsd', hr * jax.nn.silu(rnn_gate), w_rnn_out[layer])

        q = partial_rope(q.reshape(B, S, N_ATTN_HEADS, HEAD_DIM), pos)
        k = partial_rope(k.reshape(B, S, N_ATTN_HEADS, HEAD_DIM), pos)
        v = v.reshape(B, S, N_ATTN_HEADS, HEAD_DIM)
        q = q.reshape(B, S, N_GROUPS, HEADS_PER_GROUP, HEAD_DIM)
        k = k.reshape(B, S, N_GROUPS, HEADS_PER_GROUP, HEAD_DIM)
        v = v.reshape(B, S, N_GROUPS, HEADS_PER_GROUP, HEAD_DIM)
        outs, dens = [], []
        for g, (window, dilation) in enumerate(DILATED_GROUPS):
            o_g, d_g = dilated_group_attention(q[:, :, g], k[:, :, g], v[:, :, g], window, dilation)
            outs.append(o_g)
            dens.append(d_g)
        alpha = jax.nn.softmax(jnp.stack(dens, axis=0), axis=0)
        o = jnp.sum(alpha[..., None] * jnp.stack(outs, axis=0), axis=0)
        o = o.reshape(B, S, D_ATTN_OUT).astype(x.dtype)
        y_attn = jnp.einsum('bsc,cd->bsd', o * jax.nn.silu(attn_gate), w_attn_out[layer])

        merged = jax.nn.sigmoid(g_rnn) * y_rnn + jax.nn.sigmoid(g_attn) * y_attn
        y = jnp.einsum('bsd,de->bse', merged, w_o[layer])
        x = x + rms_norm(y, ln_post_g[layer])
    return x
```

```cpp
#include <hip/hip_runtime.h>
#include <stdint.h>
#include <math.h>

typedef unsigned short bf16;
__device__ __forceinline__ unsigned f2bf(float f) { unsigned u = __builtin_bit_cast(unsigned, f); return (u + 0x7fffu + ((u >> 16) & 1u)) >> 16; }
__device__ __forceinline__ float bf2f(bf16 h) { return __builtin_bit_cast(float, ((unsigned)h) << 16); }

constexpr int NB = 4, SEQ = 2048, TOK = NB * SEQ, DM = 2048, DIN = 18432, DRNN = 2048, DATT = 1024;
constexpr int C_RX = 0, C_RG = 2048, C_Q = 4096, C_K = 7168, C_V = 10240, C_AG = 13312, C_GR = 14336, C_GA = 16384;
constexpr float EPS = 1e-6f;

__global__ __launch_bounds__(256) void k_rmsnorm_pre(const float* x, const float* g, float* h) {
    const int row = blockIdx.x, tid = threadIdx.x;
    const float* xr = x + (size_t)row * DM;
    float v[8]; float s = 0.f;
#pragma unroll
    for (int j = 0; j < 8; ++j) { v[j] = xr[tid + 256 * j]; s += v[j] * v[j]; }
    __shared__ float red[256];
    red[tid] = s; __syncthreads();
    for (int o = 128; o > 0; o >>= 1) { if (tid < o) red[tid] += red[tid + o]; __syncthreads(); }
    const float rs = rsqrtf(red[0] / DM + EPS);
#pragma unroll
    for (int j = 0; j < 8; ++j) h[(size_t)row * DM + tid + 256 * j] = v[j] * rs * g[tid + 256 * j];
}

template <int EPI>
__global__ __launch_bounds__(256) void k_gemm_naive(const float* A, int lda, const float* B, int ldb, void* C, int ldc, int K) {
    __shared__ float As[16][132];
    __shared__ float Bs[16][132];
    const int tid = threadIdx.x, tx = tid & 15, ty = tid >> 4;
    const int m0 = blockIdx.y * 128, n0 = blockIdx.x * 128;
    float acc[8][8];
#pragma unroll
    for (int i = 0; i < 8; ++i)
#pragma unroll
        for (int j = 0; j < 8; ++j) acc[i][j] = 0.f;
    const int ar = tid >> 1, ak = (tid & 1) * 8;
    const int bk = tid >> 4, bc = (tid & 15) * 8;
    for (int k0 = 0; k0 < K; k0 += 16) {
        const float4 a0 = *(const float4*)(A + (size_t)(m0 + ar) * lda + k0 + ak);
        const float4 a1 = *(const float4*)(A + (size_t)(m0 + ar) * lda + k0 + ak + 4);
        const float4 b0 = *(const float4*)(B + (size_t)(k0 + bk) * ldb + n0 + bc);
        const float4 b1 = *(const float4*)(B + (size_t)(k0 + bk) * ldb + n0 + bc + 4);
        __syncthreads();
        As[ak + 0][ar] = a0.x; As[ak + 1][ar] = a0.y; As[ak + 2][ar] = a0.z; As[ak + 3][ar] = a0.w;
        As[ak + 4][ar] = a1.x; As[ak + 5][ar] = a1.y; As[ak + 6][ar] = a1.z; As[ak + 7][ar] = a1.w;
        *(float4*)&Bs[bk][bc] = b0; *(float4*)&Bs[bk][bc + 4] = b1;
        __syncthreads();
#pragma unroll
        for (int kk = 0; kk < 16; ++kk) {
            float a[8], b[8];
#pragma unroll
            for (int i = 0; i < 8; ++i) a[i] = As[kk][ty * 8 + i];
#pragma unroll
            for (int j = 0; j < 8; ++j) b[j] = Bs[kk][tx * 8 + j];
#pragma unroll
            for (int i = 0; i < 8; ++i)
#pragma unroll
                for (int j = 0; j < 8; ++j) acc[i][j] = fmaf(a[i], b[j], acc[i][j]);
        }
    }
#pragma unroll
    for (int i = 0; i < 8; ++i) {
        const size_t off = (size_t)(m0 + ty * 8 + i) * ldc + n0 + tx * 8;
#pragma unroll
        for (int j = 0; j < 8; ++j) {
            if (EPI == 0) ((bf16*)C)[off + j] = (bf16)f2bf(acc[i][j]);
            else ((float*)C)[off + j] = acc[i][j];
        }
    }
}

__global__ void k_conv(const bf16* proj, const float* conv_w, const float* conv_b, float* xc) {
    const size_t idx = (size_t)blockIdx.x * blockDim.x + threadIdx.x;
    const int c = (int)(idx % DRNN); const int tok = (int)(idx / DRNN); const int s = tok % SEQ;
    float acc = conv_b[c];
#pragma unroll
    for (int j = 0; j < 4; ++j) { const int sj = s - 3 + j; if (sj >= 0) acc += conv_w[j * DRNN + c] * bf2f(proj[(size_t)(tok - 3 + j) * DIN + C_RX + c]); }
    xc[idx] = acc;
}

__global__ __launch_bounds__(128) void k_gates(const float* xc, const float* w_rg, const float* b_rg, const float* w_ig, const float* b_ig, const float* lam, float* a_out, float* b_out) {
    const int n = blockIdx.x & 15, tg = blockIdx.x >> 4, d = threadIdx.x, c = n * 128 + d;
    __shared__ float xs[8][128];
    for (int i = 0; i < 8; ++i) xs[i][d] = xc[(size_t)(tg * 8 + i) * DRNN + c];
    __syncthreads();
    float r[8], g[8];
#pragma unroll
    for (int i = 0; i < 8; ++i) { r[i] = 0.f; g[i] = 0.f; }
    for (int k = 0; k < 128; ++k) {
        const float wr = w_rg[((size_t)n * 128 + k) * 128 + d], wi = w_ig[((size_t)n * 128 + k) * 128 + d];
#pragma unroll
        for (int i = 0; i < 8; ++i) { r[i] = fmaf(xs[i][k], wr, r[i]); g[i] = fmaf(xs[i][k], wi, g[i]); }
    }
    const float L = lam[c]; const float sp = (L > 0.f) ? log1pf(expf(-L)) : (-L + log1pf(expf(L)));
#pragma unroll
    for (int i = 0; i < 8; ++i) {
        const float rr = 1.f / (1.f + expf(-(r[i] + b_rg[c]))), ii = 1.f / (1.f + expf(-(g[i] + b_ig[c])));
        const float la = -8.f * rr * sp;
        const size_t o = (size_t)(tg * 8 + i) * DRNN + c;
        a_out[o] = expf(la);
        b_out[o] = sqrtf(-expm1f(2.f * la)) * (ii * xs[i][d]);
    }
}

__global__ void k_scan(const float* a, float* b, const bf16* proj) {
    const int idx = blockIdx.x * blockDim.x + threadIdx.x;
    const int c = idx % DRNN, bb = idx / DRNN;
    float h = 0.f;
    for (int s = 0; s < SEQ; ++s) {
        const size_t o = (size_t)(bb * SEQ + s) * DRNN + c;
        h = a[o] * h + b[o];
        const float gt = bf2f(proj[(size_t)(bb * SEQ + s) * DIN + C_RG + c]);
        b[o] = h * (gt / (1.f + expf(-gt)));
    }
}

__global__ void k_rope(bf16* proj) {
    const size_t idx = (size_t)blockIdx.x * blockDim.x + threadIdx.x;
    const int i = (int)(idx % 16); const int hh = (int)((idx / 16) % 48); const int tok = (int)(idx / (16 * 48));
    const int s = tok % SEQ;
    const int col = (hh < 24 ? C_Q + hh * 128 : C_K + (hh - 24) * 128);
    bf16* p = proj + (size_t)tok * DIN + col;
    const float inv = expf(-logf(500000.f) * (float)i * (2.0f / 32.f));
    const float ang = (float)s * inv;
    const float cs = cosf(ang), sn = sinf(ang);
    const float t1 = bf2f(p[i]), t2 = bf2f(p[i + 16]);
    p[i] = (bf16)f2bf(t1 * cs - t2 * sn);
    p[i + 16] = (bf16)f2bf(t2 * cs + t1 * sn);
}

__global__ __launch_bounds__(256) void k_attn_naive(const bf16* proj, float* og, float* ld) {
    const int wave = (int)(((size_t)blockIdx.x * blockDim.x + threadIdx.x) >> 6), lane = threadIdx.x & 63;
    const int head = wave % 24, tok = wave / 24;
    const int b = tok / SEQ, s = tok % SEQ, g = head / 8, hs = head % 8;
    const int dil = (g == 0) ? 1 : (g == 1 ? 4 : 16);
    const int l = s / dil, r = s % dil;
    const float scale = 0.08838834764831845f;
    const bf16* qp = proj + (size_t)tok * DIN + C_Q + head * 128 + lane * 2;
    const float q0 = bf2f(qp[0]) * scale, q1 = bf2f(qp[1]) * scale;
    float m = -1e30f, ls = 0.f, o0 = 0.f, o1 = 0.f;
    const int lk0 = (l - 128 > 0) ? l - 128 : 0;
    for (int lk = lk0; lk <= l; ++lk) {
        const size_t kt = (size_t)(b * SEQ + lk * dil + r) * DIN;
        const bf16* kp = proj + kt + C_K + head * 128 + lane * 2;
        const bf16* vp = proj + kt + C_V + head * 128 + lane * 2;
        float sc = q0 * bf2f(kp[0]) + q1 * bf2f(kp[1]);
#pragma unroll
        for (int o = 1; o < 64; o <<= 1) sc += __shfl_xor(sc, o);
        const float mn = fmaxf(m, sc), corr = expf(m - mn), p = expf(sc - mn);
        ls = ls * corr + p; o0 = o0 * corr + p * bf2f(vp[0]); o1 = o1 * corr + p * bf2f(vp[1]); m = mn;
    }
    float* op = og + ((size_t)g * TOK + tok) * DATT + hs * 128 + lane * 2;
    op[0] = o0 / ls; op[1] = o1 / ls;
    if (lane == 0) ld[((size_t)g * TOK + tok) * 8 + hs] = m + logf(ls);
}

__global__ void k_merge_attn(const float* og, const float* ld, const bf16* proj, float* yin) {
    const size_t idx = (size_t)blockIdx.x * blockDim.x + threadIdx.x;
    const int c = (int)(idx % DATT); const int tok = (int)(idx / DATT); const int hs = c / 128;
    const float l0 = ld[((size_t)0 * TOK + tok) * 8 + hs], l1 = ld[((size_t)1 * TOK + tok) * 8 + hs], l2 = ld[((size_t)2 * TOK + tok) * 8 + hs];
    const float mx = fmaxf(l0, fmaxf(l1, l2));
    const float e0 = expf(l0 - mx), e1 = expf(l1 - mx), e2 = expf(l2 - mx), inv = 1.f / (e0 + e1 + e2);
    const float o = (e0 * og[((size_t)0 * TOK + tok) * DATT + c] + e1 * og[((size_t)1 * TOK + tok) * DATT + c] + e2 * og[((size_t)2 * TOK + tok) * DATT + c]) * inv;
    const float gt = bf2f(proj[(size_t)tok * DIN + C_AG + c]);
    yin[idx] = o * (gt / (1.f + expf(-gt)));
}

__global__ void k_merge2(float* y_rnn, const float* y_attn, const bf16* proj) {
    const size_t idx = (size_t)blockIdx.x * blockDim.x + threadIdx.x;
    const int c = (int)(idx % DM); const int tok = (int)(idx / DM);
    const float gr = bf2f(proj[(size_t)tok * DIN + C_GR + c]), ga = bf2f(proj[(size_t)tok * DIN + C_GA + c]);
    y_rnn[idx] = y_rnn[idx] / (1.f + expf(-gr)) + y_attn[idx] / (1.f + expf(-ga));
}

__global__ __launch_bounds__(256) void k_final(const float* x, const float* y, const float* g, float* out) {
    const int row = blockIdx.x, tid = threadIdx.x;
    const float* yr = y + (size_t)row * DM;
    float v[8]; float s = 0.f;
#pragma unroll
    for (int j = 0; j < 8; ++j) { v[j] = yr[tid + 256 * j]; s += v[j] * v[j]; }
    __shared__ float red[256];
    red[tid] = s; __syncthreads();
    for (int o = 128; o > 0; o >>= 1) { if (tid < o) red[tid] += red[tid + o]; __syncthreads(); }
    const float rs = rsqrtf(red[0] / DM + EPS);
#pragma unroll
    for (int j = 0; j < 8; ++j) { const size_t o = (size_t)row * DM + tid + 256 * j; out[o] = x[o] + v[j] * rs * g[tid + 256 * j]; }
}

extern "C" void kernel_launch(void* const* d_in, const int* in_sizes, int n_in, void* d_out, int out_size, void* d_ws, size_t ws_size, hipStream_t stream) {
    const float* x = (const float*)d_in[0]; const float* ln_pre = (const float*)d_in[1]; const float* w_in = (const float*)d_in[2];
    const float* conv_w = (const float*)d_in[3]; const float* conv_b = (const float*)d_in[4];
    const float* w_rg = (const float*)d_in[5]; const float* b_rg = (const float*)d_in[6]; const float* w_ig = (const float*)d_in[7]; const float* b_ig = (const float*)d_in[8];
    const float* lam = (const float*)d_in[9]; const float* w_rnn = (const float*)d_in[10]; const float* w_att = (const float*)d_in[11]; const float* w_o = (const float*)d_in[12];
    const float* ln_post = (const float*)d_in[13];
    float* out = (float*)d_out;
    char* ws = (char*)d_ws;
    const size_t MiB = 1u << 20;
    bf16* proj = (bf16*)ws;
    float* bufA = (float*)(ws + 288 * MiB);
    float* bufB = (float*)(ws + 352 * MiB);
    float* bufC = (float*)(ws + 416 * MiB);
    float* bufD = (float*)(ws + 480 * MiB);
    float* ldb = (float*)(ws + 544 * MiB);

    k_rmsnorm_pre<<<TOK, 256, 0, stream>>>(x, ln_pre, bufA);
    k_gemm_naive<0><<<dim3(DIN / 128, TOK / 128), 256, 0, stream>>>(bufA, DM, w_in, DIN, proj, DIN, DM);
    k_conv<<<TOK * DRNN / 256, 256, 0, stream>>>(proj, conv_w, conv_b, bufA);
    k_gates<<<16 * (TOK / 8), 128, 0, stream>>>(bufA, w_rg, b_rg, w_ig, b_ig, lam, bufB, bufC);
    k_scan<<<NB * DRNN / 64, 64, 0, stream>>>(bufB, bufC, proj);
    k_rope<<<TOK * 48 * 16 / 256, 256, 0, stream>>>(proj);
    k_attn_naive<<<TOK * 24 / 4, 256, 0, stream>>>(proj, bufA, ldb);
    k_merge_attn<<<TOK * DATT / 256, 256, 0, stream>>>(bufA, ldb, proj, bufD);
    k_gemm_naive<1><<<dim3(DM / 128, TOK / 128), 256, 0, stream>>>(bufC, DRNN, w_rnn, DM, bufA, DM, DRNN);
    k_gemm_naive<1><<<dim3(DM / 128, TOK / 128), 256, 0, stream>>>(bufD, DATT, w_att, DM, bufB, DM, DATT);
    k_merge2<<<TOK * DM / 256, 256, 0, stream>>>(bufA, bufB, proj);
    k_gemm_naive<1><<<dim3(DM / 128, TOK / 128), 256, 0, stream>>>(bufA, DM, w_o, DM, bufD, DM, DM);
    k_final<<<TOK, 256, 0, stream>>>(x, bufD, ln_post, out);
}
```
